# Optimizing an MI355X kernel written in HIP

```python
import math
import jax, jax.numpy as jnp
from jax import lax
import numpy as np

D_MODEL = 1024
BATCH = 2
SEQ = 8192
DEPTH = 1

CHUNK = 64
BLOCK_Q = 128
SB_HEADS = 8
SB_HEAD_DIM = 64
SB_WIDTH = SB_HEADS * SB_HEAD_DIM
DIFF_HEADS = 4
DIFF_HEAD_DIM = 64
DIFF_WIDTH = DIFF_HEADS * 2 * DIFF_HEAD_DIM
REL_BUCKETS = 32
REL_MAX_DIST = 128
D_FF = 4 * D_MODEL
N_BRANCHES = 2
IN_COLS = 3 * SB_WIDTH + 3 * DIFF_WIDTH + N_BRANCHES * D_MODEL
NORM_EPS = 1e-6

kernel_name = "hybrid_stickbreak_diffattn_block"


def rms_norm(x, g):
    xf = x.astype(jnp.float32)
    y = xf * lax.rsqrt(jnp.mean(xf * xf, axis=-1, keepdims=True) + NORM_EPS)
    return (y * g.astype(jnp.float32)).astype(x.dtype)


def t5_bucket(rel):
    half = REL_BUCKETS // 2
    max_exact = half // 2
    ret = jnp.where(rel > 0, half, 0)
    n = jnp.abs(rel)
    nf = jnp.maximum(n, 1).astype(jnp.float32)
    large = max_exact + (jnp.log(nf / max_exact) / math.log(REL_MAX_DIST / max_exact)
                         * (half - max_exact)).astype(jnp.int32)
    large = jnp.minimum(large, half - 1)
    return ret + jnp.where(n < max_exact, n, large)


def to_blocks(t):
    b, s, h, d = t.shape
    return t.reshape(b, s // BLOCK_Q, BLOCK_Q, h, d).transpose(1, 0, 3, 2, 4)


def from_blocks(t):
    nb, b, h, q, d = t.shape
    return t.transpose(1, 0, 3, 2, 4).reshape(b, nb * q, h * d)


def stick_breaking_attention(q, k, v):
    seq = q.shape[1]
    scale = SB_HEAD_DIM ** -0.5
    kh = k.transpose(0, 2, 1, 3)
    vh = v.transpose(0, 2, 1, 3)
    k_pos = jnp.arange(seq, dtype=jnp.int32)
    q_pos = k_pos.reshape(seq // BLOCK_Q, BLOCK_Q)

    def block(args):
        qb, qp = args
        z = jnp.einsum('bhqd,bhkd->bhqk', qb, kh).astype(jnp.float32) * scale
        causal = k_pos[None, :] < qp[:, None]
        log_beta = jax.nn.log_sigmoid(z)
        log_one_minus = jnp.where(causal, jax.nn.log_sigmoid(-z), 0.0)
        shifted = jnp.concatenate([log_one_minus[..., 1:], jnp.zeros_like(log_one_minus[..., :1])], axis=-1)
        tail = lax.cumsum(shifted, axis=shifted.ndim - 1, reverse=True)
        w = jnp.where(causal, jnp.exp(log_beta + tail), 0.0)
        return jnp.einsum('bhqk,bhkd->bhqd', w.astype(vh.dtype), vh)

    out = lax.map(block, (to_blocks(q), q_pos))
    return from_blocks(out)


def differential_attention(q1, q2, k1, k2, v, lam, rel_bias):
    seq = q1.shape[1]
    scale = DIFF_HEAD_DIM ** -0.5
    k1h = k1.transpose(0, 2, 1, 3)
    k2h = k2.transpose(0, 2, 1, 3)
    vh = v.transpose(0, 2, 1, 3)
    k_pos = jnp.arange(seq, dtype=jnp.int32)
    q_pos = k_pos.reshape(seq // BLOCK_Q, BLOCK_Q)
    neg = jnp.finfo(jnp.float32).min
    table = rel_bias.astype(jnp.float32)

    def block(args):
        q1b, q2b, qp = args
        allowed = k_pos[None, :] < (qp[:, None] // CHUNK + 1) * CHUNK
        bias = jnp.transpose(table[t5_bucket(k_pos[None, :] - qp[:, None])], (2, 0, 1))

        def probs(qb, kh):
            s = jnp.einsum('bhqd,bhkd->bhqk', qb, kh).astype(jnp.float32) * scale + bias
            return jax.nn.softmax(jnp.where(allowed, s, neg), axis=-1)

        a = probs(q1b, k1h) - lam * probs(q2b, k2h)
        return jnp.einsum('bhqk,bhkd->bhqd', a.astype(vh.dtype), vh)

    out = lax.map(block, (to_blocks(q1), to_blocks(q2), q_pos))
    nb, b, h, q, d = out.shape
    return out.transpose(1, 0, 3, 2, 4).reshape(b, nb * q, h, d)


def setup_inputs(seed: int = 0) -> dict:
    key = jax.random.key(seed)
    ks = jax.random.split(key, 20)
    f32 = jnp.float32

    def w(k, shape, fan_in):
        return jax.random.normal(k, shape, f32) * (fan_in ** -0.5)

    def gain(k, shape):
        return 1.0 + 0.02 * jax.random.normal(k, shape, f32)

    return {
        "x": jax.random.normal(ks[0], (BATCH, SEQ, D_MODEL), f32),
        "w_in": w(ks[1], (DEPTH, D_MODEL, IN_COLS), D_MODEL),
        "w_sb_out": w(ks[2], (DEPTH, SB_WIDTH, D_MODEL), SB_WIDTH),
        "w_diff_out": w(ks[3], (DEPTH, DIFF_WIDTH, D_MODEL), DIFF_WIDTH),
        "w_o": w(ks[4], (DEPTH, D_MODEL, D_MODEL), D_MODEL),
        "lambda_q1": 0.1 * jax.random.normal(ks[5], (DEPTH, DIFF_HEAD_DIM), f32),
        "lambda_k1": 0.1 * jax.random.normal(ks[6], (DEPTH, DIFF_HEAD_DIM), f32),
        "lambda_q2": 0.1 * jax.random.normal(ks[7], (DEPTH, DIFF_HEAD_DIM), f32),
        "lambda_k2": 0.1 * jax.random.normal(ks[8], (DEPTH, DIFF_HEAD_DIM), f32),
        "w_subln": gain(ks[9], (DEPTH, 2 * DIFF_HEAD_DIM)),
        "rel_bias": 0.5 * jax.random.normal(ks[10], (REL_BUCKETS, DIFF_HEADS), f32),
        "g_pre_mix": gain(ks[11], (DEPTH, D_MODEL)),
        "g_post_mix": gain(ks[12], (DEPTH, D_MODEL)),
        "g_pre_mlp": gain(ks[13], (DEPTH, D_MODEL)),
        "g_post_mlp": gain(ks[14], (DEPTH, D_MODEL)),
        "w_up": w(ks[15], (DEPTH, D_MODEL, D_FF), D_MODEL),
        "w_down": w(ks[16], (DEPTH, D_FF, D_MODEL), D_FF),
    }


def reference(x, w_in, w_sb_out, w_diff_out, w_o, lambda_q1, lambda_k1, lambda_q2, lambda_k2,
              w_subln, rel_bias, g_pre_mix, g_post_mix, g_pre_mlp, g_post_mlp, w_up, w_down):
    b, s, _ = x.shape
    for l in range(DEPTH):
        h = rms_norm(x, g_pre_mix[l])
        proj = h @ w_in[l]
        c0 = 3 * SB_WIDTH
        c1 = c0 + 3 * DIFF_WIDTH
        sb_q, sb_k, sb_v = jnp.split(proj[..., :c0], 3, axis=-1)
        d_q, d_k, d_v = jnp.split(proj[..., c0:c1], 3, axis=-1)
        gates = jax.nn.sigmoid(proj[..., c1:].astype(jnp.float32)).astype(x.dtype)
        gate_sb, gate_diff = jnp.split(gates, N_BRANCHES, axis=-1)

        sb_shape = (b, s, SB_HEADS, SB_HEAD_DIM)
        y_sb = stick_breaking_attention(sb_q.reshape(sb_shape), sb_k.reshape(sb_shape), sb_v.reshape(sb_shape))

        d_q = d_q.reshape(b, s, DIFF_HEADS, 2, DIFF_HEAD_DIM)
        d_k = d_k.reshape(b, s, DIFF_HEADS, 2, DIFF_HEAD_DIM)
        d_v = d_v.reshape(b, s, DIFF_HEADS, 2 * DIFF_HEAD_DIM)
        lam_init = 0.8 - 0.6 * math.exp(-0.3 * l)
        lam = (jnp.exp(jnp.sum(lambda_q1[l].astype(jnp.float32) * lambda_k1[l].astype(jnp.float32)))
               - jnp.exp(jnp.sum(lambda_q2[l].astype(jnp.float32) * lambda_k2[l].astype(jnp.float32)))
               + lam_init)
        y_diff = differential_attention(d_q[..., 0, :], d_q[..., 1, :], d_k[..., 0, :], d_k[..., 1, :],
                                        d_v, lam, rel_bias)
        y_diff = (rms_norm(y_diff, w_subln[l]) * (1.0 - lam_init)).reshape(b, s, DIFF_WIDTH)

        merged = gate_sb * (y_sb @ w_sb_out[l]) + gate_diff * (y_diff @ w_diff_out[l])
        x = x + rms_norm(merged @ w_o[l], g_post_mix[l])

        h = rms_norm(x, g_pre_mlp[l])
        u = jnp.square(jax.nn.relu(h @ w_up[l]))
        x = x + rms_norm(u @ w_down[l], g_post_mlp[l])
    return x
```

```cpp
#include <hip/hip_runtime.h>
#include <cstdio>
#include <cstdint>

typedef unsigned short bf16;
typedef short bf16x8 __attribute__((ext_vector_type(8)));
typedef float f32x4 __attribute__((ext_vector_type(4)));
typedef unsigned v4u __attribute__((ext_vector_type(4)));
#define GAS __attribute__((address_space(1)))
#define LAS __attribute__((address_space(3)))

constexpr int BATCH = 2, SEQ = 8192, DM = 1024, M = BATCH * SEQ, NIN = 5120, FF = 4096;
constexpr int SBH = 8, DFH = 4;
constexpr float NORM_EPS = 1e-6f;
constexpr float LOG2E = 1.4426950408889634f;
constexpr float C2 = 0.125f * LOG2E;
constexpr float LAM_INIT = 0.2f;

constexpr size_t MiB = 1u << 20;
constexpr size_t WS_CTL = 0, CTL_ZERO_BYTES = 1 * MiB;
constexpr size_t WS_WIN = 2 * MiB, WS_WSB = 12 * MiB, WS_WDF = 13 * MiB, WS_WO = 14 * MiB, WS_WUP = 16 * MiB, WS_WDN = 24 * MiB;
constexpr size_t WS_XCH = 32 * MiB, WS_MISC = 34 * MiB;
constexpr size_t WS_SBQ = 36 * MiB, WS_SBK = 52 * MiB, WS_SBV = 68 * MiB, WS_DQ = 84 * MiB, WS_DK = 100 * MiB, WS_DV = 116 * MiB;
constexpr size_t WS_GSB = 132 * MiB, WS_GDF = 164 * MiB;
constexpr size_t WS_XN = 196 * MiB;
constexpr size_t WS_OD = WS_XN;
constexpr size_t WS_MRG = WS_SBK;
constexpr size_t WS_H = 36 * MiB;
constexpr size_t WS_O1F = 100 * MiB, WS_O2F = 164 * MiB;
constexpr size_t WS_END = 256 * MiB;

__device__ __forceinline__ float bf2f(bf16 v) { return __uint_as_float((unsigned)v << 16); }
__device__ __forceinline__ unsigned f2bf(float f) { unsigned u = __builtin_bit_cast(unsigned, f); return (u + 0x7fffu + ((u >> 16) & 1u)) >> 16; }
__device__ __forceinline__ unsigned pk2(float lo, float hi) { return f2bf(lo) | (f2bf(hi) << 16); }
__device__ __forceinline__ float wave_sum(float v) {
#pragma unroll
    for (int o = 1; o < 64; o <<= 1) v += __shfl_xor(v, o);
    return v;
}
#define LDS_WAIT() asm volatile("s_waitcnt lgkmcnt(0)" ::: "memory")

__device__ __forceinline__ int t5_bucket(int rel) {
    const int n = rel < 0 ? -rel : rel;
    int b;
    if (n < 8) b = n;
    else b = 8 + (n >= 12) + (n >= 16) + (n >= 23) + (n >= 32) + (n >= 46) + (n >= 64) + (n >= 91);
    return b + (rel > 0 ? 16 : 0);
}

__device__ __forceinline__ void p0_transpose_item(const float* W, int K, int N, bf16* WT, LAS float* scr, int item, int lane, const float* gv, int gmod, float gs) {
    const int nblk = N / 32, kb = item / nblk, nb = item % nblk, k0 = 64 * kb, n0 = 32 * nb;
#pragma unroll 8
    for (int i = 0; i < 32; ++i) { const int kk = 2 * i + (lane >> 5); const float sc = gv ? gv[(k0 + kk) % gmod] * gs : 1.0f;
        scr[kk * 33 + (lane & 31)] = W[(size_t)(k0 + kk) * N + n0 + (lane & 31)] * sc; }
    LDS_WAIT(); asm volatile("" ::: "memory");
    const int c = lane & 7;
#pragma unroll
    for (int j = 0; j < 4; ++j) { const int n = (lane >> 3) + 8 * j; const LAS float* s = scr + (8 * c) * 33 + n;
        v4u o; o.x = pk2(s[0 * 33], s[1 * 33]); o.y = pk2(s[2 * 33], s[3 * 33]); o.z = pk2(s[4 * 33], s[5 * 33]); o.w = pk2(s[6 * 33], s[7 * 33]);
        *(GAS v4u*)(WT + (size_t)(n0 + n) * K + k0 + 8 * c) = o; }
    LDS_WAIT(); asm volatile("" ::: "memory");
}
__device__ __forceinline__ void rms_row_to_bf16(const float* xrow, bf16* orow, int lane) {
    const GAS f32x4* xr = (const GAS f32x4*)xrow + lane;
    f32x4 v[4]; float s = 0.f;
#pragma unroll
    for (int j = 0; j < 4; ++j) { v[j] = xr[64 * j]; s += (v[j].x * v[j].x + v[j].y * v[j].y) + (v[j].z * v[j].z + v[j].w * v[j].w); }
    const float rstd = 1.f / sqrtf(wave_sum(s) * (1.f / DM) + NORM_EPS);
    GAS unsigned long long* o8 = (GAS unsigned long long*)orow + lane;
#pragma unroll
    for (int j = 0; j < 4; ++j) o8[64 * j] = (unsigned long long)pk2(v[j].x * rstd, v[j].y * rstd) | ((unsigned long long)pk2(v[j].z * rstd, v[j].w * rstd) << 32);
}

struct Args { const float* in[17]; float* out; unsigned char* ws; int ph_lo, ph_hi; };

__global__ void __launch_bounds__(512) k_prologue(Args a) {
    extern __shared__ __attribute__((aligned(16))) unsigned char lds[];
    const int tid = threadIdx.x, lane = tid & 63, wave = tid >> 6;
    LAS float* scr = (LAS float*)((LAS unsigned char*)lds + wave * 16384);
    const int gw = blockIdx.x * 8 + wave, NGW = gridDim.x * 8;
    unsigned char* ws = a.ws;
    const float* w_in = a.in[1]; const float* w_sb = a.in[2]; const float* w_df = a.in[3]; const float* w_o = a.in[4];
    const float* w_subln = a.in[9]; const float* g_pre_mix = a.in[11]; const float* g_pre_mlp = a.in[13]; const float* w_up = a.in[15]; const float* w_dn = a.in[16];
    constexpr int I_IN = (DM / 64) * (NIN / 32), I_SB = (512 / 64) * (DM / 32), I_DF = I_SB, I_O = (DM / 64) * (DM / 32), I_UP = (DM / 64) * (FF / 32), I_DN = (FF / 64) * (DM / 32);
    constexpr int NITEMS = I_IN + I_SB + I_DF + I_O + I_UP + I_DN;
    for (int it = gw; it < NITEMS; it += NGW) {
        int r = it;
        if (r < I_IN) { p0_transpose_item(w_in, DM, NIN, (bf16*)(ws + WS_WIN), scr, r, lane, g_pre_mix, DM, 1.0f); continue; } r -= I_IN;
        if (r < I_SB) { p0_transpose_item(w_sb, 512, DM, (bf16*)(ws + WS_WSB), scr, r, lane, nullptr, 1, 1.0f); continue; } r -= I_SB;
        if (r < I_DF) { p0_transpose_item(w_df, 512, DM, (bf16*)(ws + WS_WDF), scr, r, lane, w_subln, 128, 1.0f - LAM_INIT); continue; } r -= I_DF;
        if (r < I_O) { p0_transpose_item(w_o, DM, DM, (bf16*)(ws + WS_WO), scr, r, lane, nullptr, 1, 1.0f); continue; } r -= I_O;
        if (r < I_UP) { p0_transpose_item(w_up, DM, FF, (bf16*)(ws + WS_WUP), scr, r, lane, g_pre_mlp, DM, 1.0f); continue; } r -= I_UP;
        p0_transpose_item(w_dn, FF, DM, (bf16*)(ws + WS_WDN), scr, r, lane, nullptr, 1, 1.0f);
    }
    for (int m = gw; m < M; m += NGW) rms_row_to_bf16(a.in[0] + (size_t)m * DM, (bf16*)(ws + WS_XN) + (size_t)m * DM, lane);
    if (gw == 0) {
        const float s1 = wave_sum(a.in[5][lane] * a.in[6][lane]), s2 = wave_sum(a.in[7][lane] * a.in[8][lane]);
        if (lane == 0) *(float*)(ws + WS_MISC) = expf(s1) - expf(s2) + LAM_INIT;
    }
}

template <class Epi>
__global__ void __launch_bounds__(256) k_gemm_nt(const bf16* A, const bf16* Bt, long Kl, Epi E) {
    const int K = (int)Kl;
    const int wave = threadIdx.x >> 6, lane = threadIdx.x & 63;
    const int m0 = blockIdx.y * 128 + (wave >> 1) * 64, n0 = blockIdx.x * 128 + (wave & 1) * 64;
    const int fr = lane & 15, fq = lane >> 4;
    f32x4 acc[4][4];
#pragma unroll
    for (int i = 0; i < 4; ++i)
#pragma unroll
        for (int j = 0; j < 4; ++j) acc[i][j] = (f32x4){0.f, 0.f, 0.f, 0.f};
    const bf16* ap = A + (size_t)(m0 + fr) * K + fq * 8;
    const bf16* bp = Bt + (size_t)(n0 + fr) * K + fq * 8;
    for (int k0 = 0; k0 < K; k0 += 32) {
        bf16x8 av[4], bv[4];
#pragma unroll
        for (int i = 0; i < 4; ++i) av[i] = *(const bf16x8*)(ap + (size_t)i * 16 * K + k0);
#pragma unroll
        for (int j = 0; j < 4; ++j) bv[j] = *(const bf16x8*)(bp + (size_t)j * 16 * K + k0);
#pragma unroll
        for (int i = 0; i < 4; ++i)
#pragma unroll
            for (int j = 0; j < 4; ++j) acc[i][j] = __builtin_amdgcn_mfma_f32_16x16x32_bf16(av[i], bv[j], acc[i][j], 0, 0, 0);
    }
#pragma unroll
    for (int i = 0; i < 4; ++i)
#pragma unroll
        for (int j = 0; j < 4; ++j)
#pragma unroll
            for (int r = 0; r < 4; ++r) E(m0 + 16 * i + fq * 4 + r, n0 + 16 * j + fr, acc[i][j][r]);
}
struct EpiProj { unsigned char* ws;
    __device__ __forceinline__ void operator()(int row, int col, float v) const {
        if (col < 3072) { const int t = col >> 9, c = col & 511; const float sc = (t == 0) ? 0.125f : (t == 3 ? C2 : 1.0f);
            ((bf16*)(ws + WS_SBQ + (size_t)t * 16 * MiB))[(size_t)row * 512 + c] = (bf16)f2bf(v * sc); }
        else { const int g = col - 3072, t = g >> 10, c = g & 1023; const float s = 1.0f / (1.0f + __expf(-v));
            ((bf16*)(ws + (t == 0 ? WS_GSB : WS_GDF)))[(size_t)row * 1024 + c] = (bf16)f2bf(s); } } };
struct EpiMerge { const bf16* gate; bf16* mrg; long sel;
    __device__ __forceinline__ void operator()(int row, int col, float v) const { const size_t i = (size_t)row * 1024 + col; float r = v * bf2f(gate[i]); if (sel) r += bf2f(mrg[i]); mrg[i] = (bf16)f2bf(r); } };
struct EpiF32 { float* out; long ldc;
    __device__ __forceinline__ void operator()(int row, int col, float v) const { out[(size_t)row * ldc + col] = v; } };
struct EpiUp { bf16* h;
    __device__ __forceinline__ void operator()(int row, int col, float v) const { const float r = fmaxf(v, 0.f); h[(size_t)row * FF + col] = (bf16)f2bf(r * r); } };

__global__ void __launch_bounds__(256) k_rowepi1(const float* x, const float* o, const float* g, float* out, bf16* xn) {
    const int lane = threadIdx.x & 63, row = blockIdx.x * 4 + (threadIdx.x >> 6);
    const f32x4* orow = (const f32x4*)(o + (size_t)row * DM) + lane; const f32x4* xrow = (const f32x4*)(x + (size_t)row * DM) + lane; const f32x4* gr = (const f32x4*)g + lane;
    f32x4 v[4]; float s = 0.f;
#pragma unroll
    for (int j = 0; j < 4; ++j) { v[j] = orow[64 * j]; s += (v[j].x * v[j].x + v[j].y * v[j].y) + (v[j].z * v[j].z + v[j].w * v[j].w); }
    const float r1 = 1.f / sqrtf(wave_sum(s) * (1.f / DM) + NORM_EPS); float s2 = 0.f;
#pragma unroll
    for (int j = 0; j < 4; ++j) { v[j] = xrow[64 * j] + v[j] * r1 * gr[64 * j]; s2 += (v[j].x * v[j].x + v[j].y * v[j].y) + (v[j].z * v[j].z + v[j].w * v[j].w); }
    const float r2 = 1.f / sqrtf(wave_sum(s2) * (1.f / DM) + NORM_EPS);
    f32x4* outr = (f32x4*)(out + (size_t)row * DM) + lane; unsigned long long* o8 = (unsigned long long*)(xn + (size_t)row * DM) + lane;
#pragma unroll
    for (int j = 0; j < 4; ++j) { outr[64 * j] = v[j]; o8[64 * j] = (unsigned long long)pk2(v[j].x * r2, v[j].y * r2) | ((unsigned long long)pk2(v[j].z * r2, v[j].w * r2) << 32); }
}
__global__ void __launch_bounds__(256) k_rowepi2(const float* o, const float* g, float* out) {
    const int lane = threadIdx.x & 63, row = blockIdx.x * 4 + (threadIdx.x >> 6);
    const f32x4* orow = (const f32x4*)(o + (size_t)row * DM) + lane; const f32x4* gr = (const f32x4*)g + lane; f32x4* outr = (f32x4*)(out + (size_t)row * DM) + lane;
    f32x4 v[4]; float s = 0.f;
#pragma unroll
    for (int j = 0; j < 4; ++j) { v[j] = orow[64 * j]; s += (v[j].x * v[j].x + v[j].y * v[j].y) + (v[j].z * v[j].z + v[j].w * v[j].w); }
    const float r1 = 1.f / sqrtf(wave_sum(s) * (1.f / DM) + NORM_EPS);
#pragma unroll
    for (int j = 0; j < 4; ++j) outr[64 * j] = outr[64 * j] + v[j] * r1 * gr[64 * j];
}

__global__ void __launch_bounds__(256) k_sb_naive(bf16* Q  , const bf16* Kb, const bf16* Vb) {
    const int idx = blockIdx.x * 256 + threadIdx.x;
    const int bh = idx / SEQ, t = idx % SEQ, b = bh / SBH, h = bh % SBH;
    const size_t row = (size_t)b * SEQ + t;
    float q[64], o[64];
    { const v4u* qp = (const v4u*)(Q + row * 512 + h * 64);
#pragma unroll
      for (int c = 0; c < 8; ++c) { const v4u w = qp[c]; q[8 * c] = __uint_as_float(w.x << 16); q[8 * c + 1] = __uint_as_float(w.x & 0xffff0000u); q[8 * c + 2] = __uint_as_float(w.y << 16); q[8 * c + 3] = __uint_as_float(w.y & 0xffff0000u);
          q[8 * c + 4] = __uint_as_float(w.z << 16); q[8 * c + 5] = __uint_as_float(w.z & 0xffff0000u); q[8 * c + 6] = __uint_as_float(w.w << 16); q[8 * c + 7] = __uint_as_float(w.w & 0xffff0000u); } }
#pragma unroll
    for (int d = 0; d < 64; ++d) o[d] = 0.f;
    float carry = 0.f;
    for (int s = t - 1; s >= 0; --s) {
        if (carry < -104.0f) break;
        const size_t kr = ((size_t)b * SEQ + s) * 512 + h * 64;
        const v4u* kp = (const v4u*)(Kb + kr); const v4u* vp = (const v4u*)(Vb + kr);
        float z = 0.f;
#pragma unroll
        for (int c = 0; c < 8; ++c) { const v4u w = kp[c];
            z += q[8 * c] * __uint_as_float(w.x << 16) + q[8 * c + 1] * __uint_as_float(w.x & 0xffff0000u) + q[8 * c + 2] * __uint_as_float(w.y << 16) + q[8 * c + 3] * __uint_as_float(w.y & 0xffff0000u)
               + q[8 * c + 4] * __uint_as_float(w.z << 16) + q[8 * c + 5] * __uint_as_float(w.z & 0xffff0000u) + q[8 * c + 6] * __uint_as_float(w.w << 16) + q[8 * c + 7] * __uint_as_float(w.w & 0xffff0000u); }
        const float sp = fmaxf(z, 0.f) + log1pf(expf(-fabsf(z)));
        const float w = expf(z - sp + carry);
        carry -= sp;
#pragma unroll
        for (int c = 0; c < 8; ++c) { const v4u u = vp[c];
            o[8 * c] += w * __uint_as_float(u.x << 16); o[8 * c + 1] += w * __uint_as_float(u.x & 0xffff0000u); o[8 * c + 2] += w * __uint_as_float(u.y << 16); o[8 * c + 3] += w * __uint_as_float(u.y & 0xffff0000u);
            o[8 * c + 4] += w * __uint_as_float(u.z << 16); o[8 * c + 5] += w * __uint_as_float(u.z & 0xffff0000u); o[8 * c + 6] += w * __uint_as_float(u.w << 16); o[8 * c + 7] += w * __uint_as_float(u.w & 0xffff0000u); }
    }
    { v4u* op = (v4u*)(Q + row * 512 + h * 64);
#pragma unroll
      for (int c = 0; c < 8; ++c) { v4u w; w.x = pk2(o[8 * c], o[8 * c + 1]); w.y = pk2(o[8 * c + 2], o[8 * c + 3]); w.z = pk2(o[8 * c + 4], o[8 * c + 5]); w.w = pk2(o[8 * c + 6], o[8 * c + 7]); op[c] = w; } }
}

__global__ void __launch_bounds__(256) k_diff_naive(const bf16* Qb  , const bf16* Kb, const bf16* Vb, bf16* OD, const float* rel_bias) {
    __shared__ float Ks[64][64];
    __shared__ float Vs[64][128];
    __shared__ float bt[32];
    const int tid = threadIdx.x, ql = tid & 63, dq = tid >> 6;
    int bid = blockIdx.x; const int c = bid & 127; bid >>= 7; const int map = bid & 1; bid >>= 1; const int h = bid & 3; const int b = bid >> 2;
    if (tid < 32) bt[tid] = rel_bias[tid * DFH + h] * LOG2E;
    const int qpos = c * 64 + ql; const size_t qrow = (size_t)b * SEQ + qpos;
    float q[64], o[32];
#pragma unroll
    for (int d = 0; d < 64; ++d) q[d] = bf2f(Qb[qrow * 512 + h * 128 + map * 64 + d]);
#pragma unroll
    for (int i = 0; i < 32; ++i) o[i] = 0.f;
    float mrun = -INFINITY, l = 0.f;
    for (int kt = 0; kt <= c; ++kt) {
        __syncthreads();
        for (int e = tid; e < 64 * 64; e += 256) { const int key = e >> 6, d = e & 63; Ks[key][d] = bf2f(Kb[((size_t)b * SEQ + kt * 64 + key) * 512 + h * 128 + map * 64 + d]); }
        for (int e = tid; e < 64 * 128; e += 256) { const int key = e >> 7, d = e & 127; Vs[key][d] = bf2f(Vb[((size_t)b * SEQ + kt * 64 + key) * 512 + h * 128 + d]); }
        __syncthreads();
        for (int key = 0; key < 64; ++key) {
            float s = 0.f;
#pragma unroll
            for (int d = 0; d < 64; ++d) s += q[d] * Ks[key][d];
            s += bt[t5_bucket(kt * 64 + key - qpos)];
            const float mn = fmaxf(mrun, s), alpha = exp2f(mrun - mn), p = exp2f(s - mn);
            l = l * alpha + p; mrun = mn;
#pragma unroll
            for (int i = 0; i < 32; ++i) o[i] = o[i] * alpha + p * Vs[key][dq * 32 + i];
        }
    }
    const float inv = 1.0f / l;
    bf16* op = OD + qrow * 1024 + h * 256 + map * 128 + dq * 32;
#pragma unroll
    for (int i = 0; i < 32; ++i) op[i] = (bf16)f2bf(o[i] * inv);
}
__global__ void __launch_bounds__(256) k_combine(const bf16* OD, bf16* YD, const float* lamp) {
    const int lane = threadIdx.x & 63, row = blockIdx.x * 4 + (threadIdx.x >> 6), h = lane >> 4, d8 = (lane & 15) * 8;
    const float lam = *lamp;
    const v4u a = *(const v4u*)(OD + (size_t)row * 1024 + h * 256 + d8), bq = *(const v4u*)(OD + (size_t)row * 1024 + h * 256 + 128 + d8);
    float y[8];
    y[0] = __uint_as_float(a.x << 16) - lam * __uint_as_float(bq.x << 16); y[1] = __uint_as_float(a.x & 0xffff0000u) - lam * __uint_as_float(bq.x & 0xffff0000u);
    y[2] = __uint_as_float(a.y << 16) - lam * __uint_as_float(bq.y << 16); y[3] = __uint_as_float(a.y & 0xffff0000u) - lam * __uint_as_float(bq.y & 0xffff0000u);
    y[4] = __uint_as_float(a.z << 16) - lam * __uint_as_float(bq.z << 16); y[5] = __uint_as_float(a.z & 0xffff0000u) - lam * __uint_as_float(bq.z & 0xffff0000u);
    y[6] = __uint_as_float(a.w << 16) - lam * __uint_as_float(bq.w << 16); y[7] = __uint_as_float(a.w & 0xffff0000u) - lam * __uint_as_float(bq.w & 0xffff0000u);
    float ss = 0.f;
#pragma unroll
    for (int i = 0; i < 8; ++i) ss += y[i] * y[i];
    ss += __shfl_xor(ss, 1); ss += __shfl_xor(ss, 2); ss += __shfl_xor(ss, 4); ss += __shfl_xor(ss, 8);
    const float r = 1.f / sqrtf(ss * (1.f / 128.f) + NORM_EPS);
    v4u w; w.x = pk2(y[0] * r, y[1] * r); w.y = pk2(y[2] * r, y[3] * r); w.z = pk2(y[4] * r, y[5] * r); w.w = pk2(y[6] * r, y[7] * r);
    *(v4u*)(YD + (size_t)row * 512 + h * 128 + d8) = w;
}

extern "C" void kernel_launch(void* const* d_in, const int* in_sizes, int n_in, void* d_out, int out_size, void* d_ws, size_t ws_size, hipStream_t stream) {
    static int ok = 0;
    if (ok == 0) {
        if (n_in != 17 || in_sizes[0] != M * DM || out_size != M * DM || ws_size < WS_END) { fprintf(stderr, "kernel_launch: unexpected shapes (n_in %d, ws %zu)\n", n_in, ws_size); ok = -1; return; }
        if (hipFuncSetAttribute((const void*)k_prologue, hipFuncAttributeMaxDynamicSharedMemorySize, 131072) != hipSuccess) { fprintf(stderr, "kernel_launch: hipFuncSetAttribute failed\n"); ok = -1; return; }
        ok = 1;
    }
    if (ok < 0) return;
    unsigned char* ws = (unsigned char*)d_ws;
    Args a{};
    for (int i = 0; i < 17; ++i) a.in[i] = (const float*)d_in[i];
    a.out = (float*)d_out; a.ws = ws; a.ph_lo = 0; a.ph_hi = 1;
    hipLaunchKernelGGL(k_prologue, dim3(256), dim3(512), 131072, stream, a);
    hipLaunchKernelGGL(k_gemm_nt<EpiProj>, dim3(NIN / 128, M / 128), dim3(256), 0, stream, (const bf16*)(ws + WS_XN), (const bf16*)(ws + WS_WIN), (long)DM, EpiProj{ws});
    hipLaunchKernelGGL(k_sb_naive, dim3(M * SBH / 256), dim3(256), 0, stream, (bf16*)(ws + WS_SBQ), (const bf16*)(ws + WS_SBK), (const bf16*)(ws + WS_SBV));
    hipLaunchKernelGGL(k_diff_naive, dim3(BATCH * DFH * 2 * 128), dim3(256), 0, stream, (const bf16*)(ws + WS_DQ), (const bf16*)(ws + WS_DK), (const bf16*)(ws + WS_DV), (bf16*)(ws + WS_OD), (const float*)d_in[10]);
    hipLaunchKernelGGL(k_combine, dim3(M / 4), dim3(256), 0, stream, (const bf16*)(ws + WS_OD), (bf16*)(ws + WS_DQ), (const float*)(ws + WS_MISC));
    hipLaunchKernelGGL(k_gemm_nt<EpiMerge>, dim3(DM / 128, M / 128), dim3(256), 0, stream, (const bf16*)(ws + WS_SBQ), (const bf16*)(ws + WS_WSB), 512L, EpiMerge{(const bf16*)(ws + WS_GSB), (bf16*)(ws + WS_MRG), 0L});
    hipLaunchKernelGGL(k_gemm_nt<EpiMerge>, dim3(DM / 128, M / 128), dim3(256), 0, stream, (const bf16*)(ws + WS_DQ), (const bf16*)(ws + WS_WDF), 512L, EpiMerge{(const bf16*)(ws + WS_GDF), (bf16*)(ws + WS_MRG), 1L});
    hipLaunchKernelGGL(k_gemm_nt<EpiF32>, dim3(DM / 128, M / 128), dim3(256), 0, stream, (const bf16*)(ws + WS_MRG), (const bf16*)(ws + WS_WO), (long)DM, EpiF32{(float*)(ws + WS_O1F), (long)DM});
    hipLaunchKernelGGL(k_rowepi1, dim3(M / 4), dim3(256), 0, stream, (const float*)d_in[0], (const float*)(ws + WS_O1F), (const float*)d_in[12], (float*)d_out, (bf16*)(ws + WS_XN));
    hipLaunchKernelGGL(k_gemm_nt<EpiUp>, dim3(FF / 128, M / 128), dim3(256), 0, stream, (const bf16*)(ws + WS_XN), (const bf16*)(ws + WS_WUP), (long)DM, EpiUp{(bf16*)(ws + WS_H)});
    hipLaunchKernelGGL(k_gemm_nt<EpiF32>, dim3(DM / 128, M / 128), dim3(256), 0, stream, (const bf16*)(ws + WS_H), (const bf16*)(ws + WS_WDN), (long)FF, EpiF32{(float*)(ws + WS_O2F), (long)DM});
    hipLaunchKernelGGL(k_rowepi2, dim3(M / 4), dim3(256), 0, stream, (const float*)(ws + WS_O2F), (const float*)d_in[14], (float*)d_out);
}
```
